# Optimizing an MI355X kernel written in HIP

```python
import jax, jax.numpy as jnp
from jax import lax
import numpy as np

D_MODEL = 1024
BATCH = 16
SEQ = 4096
DEPTH = 4
DEC_BATCH = 2
DEC_SEQ = 16384
PAST_LEN = 128

D_MIX = D_MODEL
A_WIDTH = D_MIX // 2
A_GROUPS = 8
CONV_W = 3
B_WIDTH = D_MIX - A_WIDTH
B_HEADS = 4
B_HEAD_DIM = B_WIDTH // B_HEADS
CHUNK = 128
PROJ_OUT = 4 * A_WIDTH + 3 * B_WIDTH
ALPHA = (2.0 * DEPTH) ** 0.25
BETA = (8.0 * DEPTH) ** -0.25
LN_EPS = 1e-5

kernel_name = "hybrid_shortconv_gmlp_encoder"


def _layernorm(x, g, b):
    xf = x.astype(jnp.float32)
    mu = jnp.mean(xf, axis=-1, keepdims=True)
    var = jnp.mean(jnp.square(xf - mu), axis=-1, keepdims=True)
    y = (xf - mu) * lax.rsqrt(var + LN_EPS)
    return (y * g.astype(jnp.float32) + b.astype(jnp.float32)).astype(x.dtype)


def _layer(x, w_in, conv_w, conv_b, sg_w, sg_b, sg_norm_g, sg_norm_b, w_out, ln_g, ln_b):
    bsz, seq, _ = x.shape
    h = jnp.einsum('bsd,de->bse', x, w_in)
    a_in, a_b, a_c, a_z, b_u, b_v, b_z = jnp.split(
        h, [A_WIDTH, 2 * A_WIDTH, 3 * A_WIDTH, 4 * A_WIDTH,
            4 * A_WIDTH + B_WIDTH, 4 * A_WIDTH + 2 * B_WIDTH], axis=-1)

    t = a_c * a_in
    tp = jnp.pad(t, ((0, 0), (1, 1), (0, 0)))
    conv = (conv_w[0] * tp[:, :-2] + conv_w[1] * tp[:, 1:-1]
            + conv_w[2] * tp[:, 2:] + conv_b)
    out_a = a_b * conv * jax.nn.silu(a_z)

    n_chunks = seq // CHUNK
    u = jax.nn.gelu(b_u)
    v = jax.nn.gelu(b_v).reshape(bsz, n_chunks, CHUNK, B_HEADS, B_HEAD_DIM)
    v = _layernorm(v, sg_norm_g.reshape(B_HEADS, B_HEAD_DIM), sg_norm_b.reshape(B_HEADS, B_HEAD_DIM))
    s = jnp.einsum('hpq,bnqhd->bnphd', sg_w, v) + jnp.transpose(sg_b)[None, None, :, :, None]
    s = s.reshape(bsz, seq, B_WIDTH)
    out_b = u * s * jax.nn.silu(b_z)

    y = jnp.einsum('bse,ed->bsd', jnp.concatenate([out_a, out_b], axis=-1), w_out)
    return _layernorm(ALPHA * x + y, ln_g, ln_b)


def _trunk(x, w_in, conv_w, conv_b, sg_w, sg_b, sg_norm_g, sg_norm_b, w_out, ln_g, ln_b):
    for l in range(DEPTH):
        x = _layer(x, w_in[l], conv_w[l], conv_b[l], sg_w[l], sg_b[l],
                   sg_norm_g[l], sg_norm_b[l], w_out[l], ln_g[l], ln_b[l])
    return x


def setup_inputs(seed: int = 0) -> dict:
    key = jax.random.key(seed)
    ks = jax.random.split(key, 12)
    f32 = jnp.float32
    x_prompt = jax.random.normal(ks[0], (BATCH, SEQ, D_MODEL), f32)
    x_sample = jax.random.normal(ks[1], (DEC_BATCH, DEC_SEQ, D_MODEL), f32)
    w_in = jax.random.normal(ks[2], (DEPTH, D_MODEL, PROJ_OUT), f32) * D_MODEL ** -0.5
    conv_w = jax.random.normal(ks[3], (DEPTH, CONV_W, A_WIDTH), f32) * CONV_W ** -0.5
    conv_b = jax.random.normal(ks[4], (DEPTH, A_WIDTH), f32) * 0.02
    sg_w = jax.random.normal(ks[5], (DEPTH, B_HEADS, CHUNK, CHUNK), f32) * CHUNK ** -0.5
    sg_b = 1.0 + 0.1 * jax.random.normal(ks[6], (DEPTH, B_HEADS, CHUNK), f32)
    sg_norm_g = 1.0 + 0.02 * jax.random.normal(ks[7], (DEPTH, B_WIDTH), f32)
    sg_norm_b = 0.02 * jax.random.normal(ks[8], (DEPTH, B_WIDTH), f32)
    w_out = jax.random.normal(ks[9], (DEPTH, D_MIX, D_MODEL), f32) * (D_MIX ** -0.5) * BETA
    ln_g = 1.0 + 0.02 * jax.random.normal(ks[10], (DEPTH, D_MODEL), f32)
    ln_b = 0.02 * jax.random.normal(ks[11], (DEPTH, D_MODEL), f32)
    return {"x_prompt": x_prompt, "x_sample": x_sample, "w_in": w_in, "conv_w": conv_w,
            "conv_b": conv_b, "sg_w": sg_w, "sg_b": sg_b, "sg_norm_g": sg_norm_g,
            "sg_norm_b": sg_norm_b, "w_out": w_out, "ln_g": ln_g, "ln_b": ln_b}


def reference(x_prompt, x_sample, w_in, conv_w, conv_b, sg_w, sg_b, sg_norm_g, sg_norm_b,
              w_out, ln_g, ln_b):
    y_prompt = _trunk(x_prompt, w_in, conv_w, conv_b, sg_w, sg_b, sg_norm_g, sg_norm_b,
                      w_out, ln_g, ln_b)
    y_sample = _trunk(x_sample, w_in, conv_w, conv_b, sg_w, sg_b, sg_norm_g, sg_norm_b,
                      w_out, ln_g, ln_b)
    return (y_prompt, y_sample)
```

```cpp
#include <hip/hip_runtime.h>
#include <hip/hip_cooperative_groups.h>
#include <cstdio>
#include <cstdint>
namespace cg = cooperative_groups;

#ifndef MK_N_LAUNCHES
#define MK_N_LAUNCHES 1
#endif

namespace pg8 {
#define PG8_LAS __attribute__((address_space(3)))
typedef unsigned short bf16_t;
typedef short bf16x8 __attribute__((ext_vector_type(8)));
typedef float f32x4 __attribute__((ext_vector_type(4)));
typedef unsigned u32x4 __attribute__((ext_vector_type(4)));
typedef unsigned u32x2 __attribute__((ext_vector_type(2)));
constexpr int BM = 256, BK = 64, HALF = 128, HTB = HALF * BK * 2  , STAGE_BYTES = 8 * HTB, NXCD = 8, WGM = 8;

__host__ __device__ __forceinline__ int lds_byte(int r, int c) { const int st = (r >> 4) * 2 + (c >> 5), rr = r & 15, cc = c & 31, ob = rr * 64 + cc * 2; return st * 1024 + (ob ^ (((ob >> 9) & 1) << 5)); }
__host__ __device__ __forceinline__ void stage_rc(int b, int& R, int& C) { const int st = b / 1024, sb = b % 1024, swz = sb ^ (((sb >> 9) & 1) << 5); R = (st >> 1) * 16 + swz / 64; C = (st & 1) * 32 + (swz % 64) / 2; }
__host__ __device__ __forceinline__ int perm32(int rho) { const int n = rho >> 4, i = rho & 15; return 8 * (i >> 2) + 4 * n + (i & 3); }

struct Unit { int pm, pn; };

struct StaticOrder {
    int nM, nN, nwg, G, c;
    __host__ __device__ void init(int M, int N, int G_, int c_) { nM = M / BM; nN = N / BM; nwg = nM * nN; G = G_; c = c_; }
    __host__ __device__ bool next(int i, Unit& u) const {
        const long L = (long)i * G + c; if (L >= nwg) return false;
        int wgid = (int)L; { const int q = nwg / NXCD, r = nwg % NXCD, xcd = wgid % NXCD, off = wgid / NXCD; wgid = (xcd < r ? xcd * (q + 1) : r * (q + 1) + (xcd - r) * q) + off; }
        const int nig = WGM * nN, gid = wgid / nig, fm = gid * WGM, gsz = (nM - fm) < WGM ? (nM - fm) : WGM;
        u.pm = fm + ((wgid % nig) % gsz); u.pn = (wgid % nig) / gsz; return true;
    }
};

__device__ __forceinline__ unsigned cvt_pk_bf16(float lo, float hi) { unsigned r; asm volatile("v_cvt_pk_bf16_f32 %0, %1, %2" : "=v"(r) : "v"(lo), "v"(hi)); return r; }

template <class Epi, class Sched, bool ALIGN_EPI = false, bool SP2 = false>
__device__ __forceinline__ void gemm_phase(PG8_LAS unsigned char* lds, const int K, const Sched& S, const Epi& E) {
    int tid_ = threadIdx.x; asm volatile("" : "+v"(tid_));
    const int tid = tid_, wid = __builtin_amdgcn_readfirstlane(tid >> 6), lane = tid & 63, wr = wid >> 2, wc = wid & 3, fr = lane & 15, fq = lane >> 4;
    const int nt = K / BK;
    unsigned voffA[2], voffB[2];
#pragma unroll
    for (int i = 0; i < 2; ++i) { int R, C; stage_rc(tid * 16 + i * 8192, R, C); const int Rb = Epi::PERM ? ((R & ~31) + perm32(R & 31)) : R;
        voffA[i] = (unsigned)(R * K + C) * 2u; voffB[i] = (unsigned)(Rb * K + C) * 2u; }
    const size_t kstep = (size_t)(BK * 2);
    const size_t hstep = (size_t)HALF * K * 2;
    const size_t tstep = 2 * hstep;
    const unsigned ldsw = (unsigned)wid * 1024u;
    const int aoff = lds_byte(wr * 64 + fr, fq * 8), boff = lds_byte(wc * 32 + fr, fq * 8);
#define PG8_SA(b, h) (((b) * 2 + (h)) * HTB)
#define PG8_SB(b, h) ((4 + (b) * 2 + (h)) * HTB)
#define PG8_STAGE(bufoff, gbase, voff) do { _Pragma("unroll") for (int _i = 0; _i < 2; ++_i) \
        __builtin_amdgcn_global_load_lds((const unsigned*)((const char*)(gbase) + (voff)[_i]), (PG8_LAS unsigned*)(lds + (bufoff) + ldsw + _i * 8192), 16, 0, 0); } while (0)
#define PG8_LDA(dst, b, h) do { _Pragma("unroll") for (int m = 0; m < 4; ++m) _Pragma("unroll") for (int k = 0; k < 2; ++k) dst[m][k] = *(const PG8_LAS bf16x8*)(lds + PG8_SA(b, h) + aoff + m * 2048 + k * 1024); } while (0)
#define PG8_LDB(dst, b, h) do { _Pragma("unroll") for (int n = 0; n < 2; ++n) _Pragma("unroll") for (int k = 0; k < 2; ++k) dst[n][k] = *(const PG8_LAS bf16x8*)(lds + PG8_SB(b, h) + boff + n * 2048 + k * 1024); } while (0)
#define PG8_MMA(ai, bj, At, Bt) do { __builtin_amdgcn_s_setprio(1); _Pragma("unroll") for (int m = 0; m < 4; ++m) _Pragma("unroll") for (int n = 0; n < 2; ++n) _Pragma("unroll") for (int k = 0; k < 2; ++k) \
        acc[ai][bj][m][n] = __builtin_amdgcn_mfma_f32_16x16x32_bf16(Bt[n][k], At[m][k], acc[ai][bj][m][n], 0, 0, 0); __builtin_amdgcn_s_setprio(0); } while (0)
#define PG8_WAIT_V(n) asm volatile("s_waitcnt vmcnt(" #n ")" ::: "memory")
#define PG8_WAIT_L(n) asm volatile("s_waitcnt lgkmcnt(" #n ")" ::: "memory")
#define PG8_BAR __builtin_amdgcn_s_barrier()
#define PG8_SCHED __builtin_amdgcn_sched_barrier(0)
    Unit cur, nxt; int ui = 0;
    if (!S.next(0, cur)) return;
    f32x4 acc[2][2][4][2];
#pragma unroll
    for (int a = 0; a < 2; ++a)
#pragma unroll
        for (int b = 0; b < 2; ++b)
#pragma unroll
            for (int m = 0; m < 4; ++m)
#pragma unroll
                for (int n = 0; n < 2; ++n) acc[a][b][m][n] = (f32x4){0.f, 0.f, 0.f, 0.f};
    bf16x8 At[4][2], B0[2][2], B1[2][2];
    const char* cA = S.pA(cur); const char* cB = S.pB(cur);
    S.a_ready(cur);
    if constexpr (SP2) {
        PG8_STAGE(PG8_SB(0, 0), cB, voffB); PG8_STAGE(PG8_SB(0, 1), cB + hstep, voffB); PG8_STAGE(PG8_SA(0, 0), cA, voffA); PG8_STAGE(PG8_SA(0, 1), cA + hstep, voffA);
        if (wr == 1) PG8_BAR;
        PG8_WAIT_V(2); PG8_BAR;
        PG8_STAGE(PG8_SB(1, 0), cB + kstep, voffB); PG8_STAGE(PG8_SA(1, 0), cA + kstep, voffA); PG8_STAGE(PG8_SB(1, 1), cB + hstep + kstep, voffB);
        PG8_WAIT_V(6); PG8_BAR;
    } else {
        PG8_STAGE(PG8_SB(0, 0), cB, voffB); PG8_STAGE(PG8_SA(0, 0), cA, voffA); PG8_STAGE(PG8_SB(0, 1), cB + hstep, voffB); PG8_STAGE(PG8_SA(0, 1), cA + hstep, voffA);
        if (wr == 1) PG8_BAR;
        PG8_WAIT_V(4); PG8_BAR;
        PG8_STAGE(PG8_SB(1, 0), cB + kstep, voffB); PG8_STAGE(PG8_SA(1, 0), cA + kstep, voffA); PG8_STAGE(PG8_SB(1, 1), cB + hstep + kstep, voffB);
        PG8_WAIT_V(6); PG8_BAR;
    }
    for (;;) {
        const bool has_next = S.next(ui + 1, nxt);
        const char* nA = has_next ? S.pA(nxt) : cA; const char* nB = has_next ? S.pB(nxt) : cB;
        for (int t = 0; t < nt; t += 2) {
            const bool last = (t == nt - 2);
            const char* a1 = cA + (size_t)(t + 1) * kstep;
            const char* a2 = last ? nA : cA + (size_t)(t + 2) * kstep; const char* b2 = last ? nB : cB + (size_t)(t + 2) * kstep;
            const char* a3 = a2 + kstep; const char* b3 = b2 + kstep;
            if (last && has_next) S.a_ready(nxt);
            if constexpr (SP2) {
            PG8_LDB(B0, 0, 0); PG8_LDB(B1, 0, 1); PG8_SCHED; PG8_LDA(At, 0, 0); PG8_STAGE(PG8_SA(1, 1), a1 + hstep, voffA);
            PG8_WAIT_V(8); PG8_WAIT_L(0); PG8_BAR; PG8_MMA(0, 0, At, B0); PG8_MMA(0, 1, At, B1); PG8_BAR; PG8_SCHED;
            PG8_LDA(At, 0, 1); PG8_STAGE(PG8_SB(0, 0), b2, voffB); PG8_STAGE(PG8_SB(0, 1), b2 + hstep, voffB); PG8_STAGE(PG8_SA(0, 0), a2, voffA);
            PG8_WAIT_V(8); PG8_WAIT_L(0); PG8_BAR; PG8_MMA(1, 0, At, B0); PG8_MMA(1, 1, At, B1); PG8_BAR; PG8_SCHED;
            PG8_LDB(B0, 1, 0); PG8_LDB(B1, 1, 1); PG8_SCHED; PG8_LDA(At, 1, 0); PG8_STAGE(PG8_SA(0, 1), a2 + hstep, voffA);
            PG8_WAIT_V(8); PG8_WAIT_L(0); PG8_BAR; PG8_MMA(0, 0, At, B0); PG8_MMA(0, 1, At, B1); PG8_BAR; PG8_SCHED;
            PG8_LDA(At, 1, 1); PG8_STAGE(PG8_SB(1, 0), b3, voffB); PG8_STAGE(PG8_SB(1, 1), b3 + hstep, voffB); PG8_STAGE(PG8_SA(1, 0), a3, voffA);
            PG8_WAIT_V(8); PG8_WAIT_L(0); PG8_BAR; PG8_MMA(1, 0, At, B0); PG8_MMA(1, 1, At, B1); PG8_BAR; PG8_SCHED;
            } else {
            PG8_LDB(B0, 0, 0); PG8_SCHED; PG8_LDA(At, 0, 0); PG8_STAGE(PG8_SA(1, 1), a1 + hstep, voffA);
            PG8_WAIT_L(8); PG8_BAR; PG8_WAIT_L(0); PG8_MMA(0, 0, At, B0); PG8_BAR; PG8_SCHED;
            PG8_LDB(B1, 0, 1); PG8_STAGE(PG8_SB(0, 0), b2, voffB);
            PG8_BAR; PG8_WAIT_L(0); PG8_MMA(0, 1, At, B1); PG8_BAR;
            PG8_LDA(At, 0, 1); PG8_STAGE(PG8_SA(0, 0), a2, voffA);
            PG8_BAR; PG8_WAIT_L(0); PG8_MMA(1, 0, At, B0); PG8_BAR; PG8_SCHED;
            PG8_STAGE(PG8_SB(0, 1), b2 + hstep, voffB);
            PG8_WAIT_V(6); PG8_BAR; PG8_MMA(1, 1, At, B1); PG8_BAR;
            PG8_LDB(B0, 1, 0); PG8_SCHED; PG8_LDA(At, 1, 0); PG8_STAGE(PG8_SA(0, 1), a2 + hstep, voffA);
            PG8_WAIT_L(8); PG8_BAR; PG8_WAIT_L(0); PG8_MMA(0, 0, At, B0); PG8_BAR; PG8_SCHED;
            PG8_LDB(B1, 1, 1); PG8_STAGE(PG8_SB(1, 0), b3, voffB);
            PG8_BAR; PG8_WAIT_L(0); PG8_MMA(0, 1, At, B1); PG8_BAR;
            PG8_LDA(At, 1, 1); PG8_STAGE(PG8_SA(1, 0), a3, voffA);
            PG8_BAR; PG8_WAIT_L(0); PG8_MMA(1, 0, At, B0); PG8_BAR; PG8_SCHED;
            PG8_STAGE(PG8_SB(1, 1), b3 + hstep, voffB);
            PG8_WAIT_V(6); PG8_BAR; PG8_MMA(1, 1, At, B1); PG8_BAR;
            }
        }
        if constexpr (ALIGN_EPI) { if (wr == 0) PG8_BAR; }
        if constexpr (!Epi::AFTER_DRAIN) { E(acc, cur, wr, wc, fr, fq); S.done(cur); }
        if (!has_next) break;
#pragma unroll
        for (int a = 0; a < 2; ++a)
#pragma unroll
            for (int b = 0; b < 2; ++b)
#pragma unroll
                for (int m = 0; m < 4; ++m)
#pragma unroll
                    for (int n = 0; n < 2; ++n) acc[a][b][m][n] = (f32x4){0.f, 0.f, 0.f, 0.f};
        cur = nxt; cA = nA; cB = nB; ++ui;
        if constexpr (ALIGN_EPI) { if (wr == 1) PG8_BAR; }
    }
    PG8_WAIT_V(0);
    if constexpr (!ALIGN_EPI) { if (wr == 0) PG8_BAR; }
    PG8_BAR;
    if constexpr (Epi::AFTER_DRAIN) { E.fused(acc, cur, wr, wc, fr, fq, lds, wid, lane); S.done(cur); }
#undef PG8_SA
#undef PG8_SB
#undef PG8_STAGE
#undef PG8_LDA
#undef PG8_LDB
#undef PG8_MMA
#undef PG8_WAIT_V
#undef PG8_WAIT_L
#undef PG8_BAR
#undef PG8_SCHED
}
}

constexpr int DM = 1024;
constexpr int NTOK_P = 16 * 4096, NTOK_S = 2 * 16384, NTOK = NTOK_P + NTOK_S;
constexpr int SEQ_P = 4096, SEQ_S = 16384;
constexpr int DEPTH = 4, PROJ = 3584, AW = 512, BW = 512, NH = 4, HD = 128, CHUNK = 128;
constexpr int NCHUNK = NTOK / CHUNK;
constexpr float ALPHA = 1.681792830507429f;
constexpr float LN_EPS = 1e-5f;
constexpr int NWAVES = 8;

constexpr size_t MiB = 1u << 20;
constexpr size_t WS_WIN = 0;
constexpr size_t WS_WOUT = 28 * MiB;
constexpr size_t WS_SGW = 36 * MiB;
constexpr size_t WS_XB = 64 * MiB;
constexpr size_t WS_TT = 256 * MiB;
constexpr size_t WS_GA = 352 * MiB;
constexpr size_t WS_GB = 448 * MiB;
constexpr size_t WS_GVT = 544 * MiB;
constexpr size_t WS_MIX = 640 * MiB;
constexpr size_t WS_END = 832 * MiB;
static_assert(WS_GA - WS_TT == WS_GB - WS_GA, "TT/GA/GB equally spaced");

constexpr int LDS_BYTES = 147456;

#define LAS __attribute__((address_space(3)))
typedef unsigned short bf16;
typedef unsigned v4u __attribute__((ext_vector_type(4)));
typedef unsigned v2u __attribute__((ext_vector_type(2)));
typedef float f32x4 __attribute__((ext_vector_type(4)));
typedef short bf16x8 __attribute__((ext_vector_type(8)));

__device__ __forceinline__ float bf_lo(unsigned u) { return __builtin_bit_cast(float, u << 16); }
__device__ __forceinline__ float bf_hi(unsigned u) { return __builtin_bit_cast(float, u & 0xffff0000u); }
__device__ __forceinline__ float silu_f(float x) { return x * __builtin_amdgcn_rcpf(1.0f + __builtin_amdgcn_exp2f(-1.4426950409f * x)); }
__device__ __forceinline__ float gelu_f(float x) { const float u = x * x; return x * __builtin_amdgcn_rcpf(1.0f + __builtin_amdgcn_exp2f(x * (-2.3022082f - 0.10294324f * u))); }

struct SchedG1 {
    pg8::StaticOrder so; const char* X; const char* W;
    __device__ __forceinline__ bool next(int i, pg8::Unit& u) const { return so.next(i, u); }
    __device__ __forceinline__ const char* pA(const pg8::Unit& u) const { return u.pn < 12 ? X + (size_t)u.pm * (256 * DM * 2) : W + (size_t)u.pn * (256 * DM * 2); }
    __device__ __forceinline__ const char* pB(const pg8::Unit& u) const { return u.pn < 12 ? W + (size_t)u.pn * (256 * DM * 2) : X + (size_t)u.pm * (256 * DM * 2); }
    __device__ __forceinline__ void a_ready(const pg8::Unit&) const {}
    __device__ __forceinline__ void done(const pg8::Unit&) const {}
};
struct SchedG2 {
    pg8::StaticOrder so; const char* A; const char* B;
    __device__ __forceinline__ bool next(int i, pg8::Unit& u) const { return so.next(i, u); }
    __device__ __forceinline__ const char* pA(const pg8::Unit& u) const { return A + (size_t)u.pm * (256 * DM * 2); }
    __device__ __forceinline__ const char* pB(const pg8::Unit& u) const { return B + (size_t)u.pn * (256 * DM * 2); }
    __device__ __forceinline__ void a_ready(const pg8::Unit&) const {}
    __device__ __forceinline__ void done(const pg8::Unit&) const {}
};

struct EpiG1 {
    static constexpr bool PERM = true, AFTER_DRAIN = false;
    bf16 *Tt, *GVT;
    __device__ __forceinline__ void operator()(const f32x4 (&acc)[2][2][4][2], const pg8::Unit& u, int wr, int wc, int fr, int fq) const {
        const int type = u.pn >> 2;
        if (type < 3) {
            bf16* base = Tt + (size_t)type * ((WS_GA - WS_TT) / 2);
            const int col0 = (u.pn & 3) * 128 + wc * 32 + 8 * fq;
#pragma unroll
            for (int ai = 0; ai < 2; ++ai)
#pragma unroll
                for (int m = 0; m < 4; ++m) {
                    const int row = u.pm * 256 + ai * 128 + wr * 64 + m * 16 + fr;
                    float o[8];
#pragma unroll
                    for (int n = 0; n < 2; ++n)
#pragma unroll
                        for (int j = 0; j < 4; ++j) {
                            const float a = acc[ai][0][m][n][j], b = acc[ai][1][m][n][j];
                            float r;
                            if (type == 0) r = a * b; else if (type == 1) r = a * silu_f(b); else r = gelu_f(a) * silu_f(b);
                            o[n * 4 + j] = r;
                        }
                    v4u w; w.x = pg8::cvt_pk_bf16(o[0], o[1]); w.y = pg8::cvt_pk_bf16(o[2], o[3]); w.z = pg8::cvt_pk_bf16(o[4], o[5]); w.w = pg8::cvt_pk_bf16(o[6], o[7]);
                    *(v4u*)(base + (size_t)row * 512 + col0) = w;
                }
        } else {
            const int hp = u.pn - 12;
#pragma unroll
            for (int ai = 0; ai < 2; ++ai)
#pragma unroll
                for (int m = 0; m < 4; ++m) {
                    const int dd = wr * 64 + m * 16 + fr, head = 2 * hp + ai;
#pragma unroll
                    for (int bj = 0; bj < 2; ++bj) {
                        const int chunk = 2 * u.pm + bj, q0 = wc * 32 + 8 * fq;
                        float o[8];
#pragma unroll
                        for (int n = 0; n < 2; ++n)
#pragma unroll
                            for (int j = 0; j < 4; ++j) o[n * 4 + j] = gelu_f(acc[ai][bj][m][n][j]);
                        v4u w; w.x = pg8::cvt_pk_bf16(o[0], o[1]); w.y = pg8::cvt_pk_bf16(o[2], o[3]); w.z = pg8::cvt_pk_bf16(o[4], o[5]); w.w = pg8::cvt_pk_bf16(o[6], o[7]);
                        *(v4u*)(GVT + ((size_t)(chunk * 4 + head) * 128 + dd) * 128 + q0) = w;
                    }
                }
        }
    }
};

struct EpiG2 {
    static constexpr bool PERM = false, AFTER_DRAIN = false;
    const float* resP; const float* resS;
    float* out;
    __device__ __forceinline__ void operator()(const f32x4 (&acc)[2][2][4][2], const pg8::Unit& u, int wr, int wc, int fr, int fq) const {
        const int col0 = u.pn * 256 + wc * 32 + 4 * fq;
#pragma unroll
        for (int ai = 0; ai < 2; ++ai)
#pragma unroll
            for (int m = 0; m < 4; ++m) {
                const int row = u.pm * 256 + ai * 128 + wr * 64 + m * 16 + fr;
                const float* rp = (row < NTOK_P ? resP + (size_t)row * DM : resS + (size_t)(row - NTOK_P) * DM) + col0;
                float* op = out + (size_t)row * DM + col0;
#pragma unroll
                for (int bj = 0; bj < 2; ++bj)
#pragma unroll
                    for (int n = 0; n < 2; ++n) {
                        const f32x4 xr = *(const f32x4*)(rp + bj * 128 + n * 16);
                        *(f32x4*)(op + bj * 128 + n * 16) = xr * ALPHA + acc[ai][bj][m][n];
                    }
                asm volatile("" ::: "memory");
            }
    }
};

struct Frame {
    LAS unsigned char* lds;
    int tid, lane, wave, vcu, G;
    const float *xP, *xS, *w_in, *conv_w, *conv_b, *sg_w, *sg_b, *sg_ng, *sg_nb, *w_out, *ln_g, *ln_b;
    float* out;
    bf16 *WIN, *WOUT, *SGW, *XB, *TT, *GA, *GB, *GVT, *MIX;
};

__device__ __forceinline__ int win_colmap(int R) {
    const int tile = R >> 8, half = (R >> 7) & 1, c = R & 127;
    if (tile < 4) return (half ? 1024 : 0) + 128 * tile + c;
    if (tile < 8) return (half ? 1536 : 512) + 128 * (tile - 4) + c;
    if (tile < 12) return (half ? 3072 : 2048) + 128 * (tile - 8) + c;
    return 2560 + 128 * (2 * (tile - 12) + half) + c;
}
__device__ __forceinline__ void p0_transpose_item(const float* W, int ldw, int src_col0, bf16* WT, int dst_row0, int k0, LAS float* scr, int lane) {
#pragma unroll 8
    for (int i = 0; i < 32; ++i) { const int kk = 2 * i + (lane >> 5); scr[kk * 33 + (lane & 31)] = W[(size_t)(k0 + kk) * ldw + src_col0 + (lane & 31)]; }
    asm volatile("s_waitcnt lgkmcnt(0)" ::: "memory");
    const int c = lane & 7;
#pragma unroll
    for (int j = 0; j < 4; ++j) { const int n = (lane >> 3) + 8 * j; const LAS float* s = scr + (8 * c) * 33 + n;
        v4u o; o.x = pg8::cvt_pk_bf16(s[0 * 33], s[1 * 33]); o.y = pg8::cvt_pk_bf16(s[2 * 33], s[3 * 33]); o.z = pg8::cvt_pk_bf16(s[4 * 33], s[5 * 33]); o.w = pg8::cvt_pk_bf16(s[6 * 33], s[7 * 33]);
        *(v4u*)(WT + (size_t)(dst_row0 + n) * DM + k0 + 8 * c) = o; }
    asm volatile("s_waitcnt lgkmcnt(0)" ::: "memory");
}
__device__ __forceinline__ void p0_prologue(Frame& F) {
    LAS float* scr = (LAS float*)(F.lds + F.wave * 16384);
    const int gw = F.vcu * NWAVES + F.wave, NGW = F.G * NWAVES;
    constexpr int I_IN = (DM / 64) * (PROJ / 32), I_OUT = (DM / 64) * (DM / 32);
    constexpr int NITEMS = DEPTH * (I_IN + I_OUT);
    for (int it = gw; it < NITEMS; it += NGW) {
        if (it < DEPTH * I_IN) { const int l = it / I_IN, r = it % I_IN, kb = r / (PROJ / 32), nb = r % (PROJ / 32);
            p0_transpose_item(F.w_in + (size_t)l * DM * PROJ, PROJ, win_colmap(32 * nb), F.WIN + (size_t)l * PROJ * DM, 32 * nb, 64 * kb, scr, F.lane); }
        else { const int r2 = it - DEPTH * I_IN, l = r2 / I_OUT, r = r2 % I_OUT, kb = r / (DM / 32), nb = r % (DM / 32);
            p0_transpose_item(F.w_out + (size_t)l * DM * DM, DM, 32 * nb, F.WOUT + (size_t)l * DM * DM, 32 * nb, 64 * kb, scr, F.lane); }
    }
    const size_t gt = (size_t)F.vcu * 512 + F.tid, NGT = (size_t)F.G * 512;
    for (size_t i = gt; i < (size_t)DEPTH * NH * 128 * 128 / 4; i += NGT) { const f32x4 v = *(const f32x4*)(F.sg_w + 4 * i);
        v2u o; o.x = pg8::cvt_pk_bf16(v.x, v.y); o.y = pg8::cvt_pk_bf16(v.z, v.w); *(v2u*)(F.SGW + 4 * i) = o; }
    for (size_t i = gt; i < (size_t)NTOK * DM / 8; i += NGT) {
        const size_t e = 8 * i; const float* src = e < (size_t)NTOK_P * DM ? F.xP + e : F.xS + (e - (size_t)NTOK_P * DM);
        const f32x4 a = *(const f32x4*)src, b = *(const f32x4*)(src + 4);
        v4u o; o.x = pg8::cvt_pk_bf16(a.x, a.y); o.y = pg8::cvt_pk_bf16(a.z, a.w); o.z = pg8::cvt_pk_bf16(b.x, b.y); o.w = pg8::cvt_pk_bf16(b.z, b.w);
        *(v4u*)(F.XB + e) = o; }
}

constexpr int VT_STRIDE = 272;
constexpr int MIX_RED_OFF = 40960, MIX_STAT_OFF = 49152;
__device__ __forceinline__ void mix_phase(Frame& F, int l) {
    const float* cw = F.conv_w + (size_t)l * 3 * AW; const float* cb = F.conv_b + (size_t)l * AW;
    const bf16* sgw = F.SGW + (size_t)l * NH * 128 * 128; const float* sgb = F.sg_b + (size_t)l * NH * CHUNK;
    const float* ng = F.sg_ng + (size_t)l * BW; const float* nb = F.sg_nb + (size_t)l * BW;
    int tid_ = threadIdx.x; asm volatile("" : "+v"(tid_));
    const int tid = tid_, lane = tid & 63, wave = __builtin_amdgcn_readfirstlane(tid >> 6), fr = lane & 15, fq = lane >> 4;
    typedef float f32x2 __attribute__((ext_vector_type(2)));
    LAS f32x2* red = (LAS f32x2*)(F.lds + MIX_RED_OFF);
    LAS f32x2* stat = (LAS f32x2*)(F.lds + MIX_STAT_OFF);
    for (int chunk = F.vcu; chunk < NCHUNK; chunk += F.G) {
        const int tok0 = chunk * CHUNK;
        const int pos0 = tok0 < NTOK_P ? (tok0 & (SEQ_P - 1)) : ((tok0 - NTOK_P) & (SEQ_S - 1));
        const int slen = tok0 < NTOK_P ? SEQ_P : SEQ_S;
        const bool has_prev = pos0 > 0, has_next = pos0 + CHUNK < slen;
        {
            const int cgp = tid & 63, r0 = tid >> 6, ch0 = 8 * cgp;
            float w0[8], w1[8], w2[8], bb[8];
#pragma unroll
            for (int e = 0; e < 8; ++e) { w0[e] = cw[ch0 + e]; w1[e] = cw[AW + ch0 + e]; w2[e] = cw[2 * AW + ch0 + e]; bb[e] = cb[ch0 + e]; }
#pragma unroll 2
            for (int it = 0; it < 16; ++it) {
                const int p = it * 8 + r0; const size_t tok = (size_t)tok0 + p;
                const v4u z4 = {0u, 0u, 0u, 0u};
                const v4u tc = *(const v4u*)(F.TT + tok * AW + ch0);
                const v4u tp = (p > 0 || has_prev) ? *(const v4u*)(F.TT + (tok - 1) * AW + ch0) : z4;
                const v4u tn = (p < CHUNK - 1 || has_next) ? *(const v4u*)(F.TT + (tok + 1) * AW + ch0) : z4;
                const v4u ga = *(const v4u*)(F.GA + tok * AW + ch0);
                v4u o;
#pragma unroll
                for (int k = 0; k < 4; ++k) {
                    const float c0 = w0[2 * k] * bf_lo(tp[k]) + w1[2 * k] * bf_lo(tc[k]) + w2[2 * k] * bf_lo(tn[k]) + bb[2 * k];
                    const float c1 = w0[2 * k + 1] * bf_hi(tp[k]) + w1[2 * k + 1] * bf_hi(tc[k]) + w2[2 * k + 1] * bf_hi(tn[k]) + bb[2 * k + 1];
                    o[k] = pg8::cvt_pk_bf16(bf_lo(ga[k]) * c0, bf_hi(ga[k]) * c1);
                }
                *(v4u*)(F.MIX + tok * DM + ch0) = o;
            }
        }
        for (int h = 0; h < NH; ++h) {
            const int qg = tid & 15, dsub = tid >> 4;
            const bf16* gv = F.GVT + ((size_t)(chunk * 4 + h) * 128) * 128;
            v4u v[4];
#pragma unroll
            for (int i = 0; i < 4; ++i) v[i] = *(const v4u*)(gv + (size_t)(dsub + 32 * i) * 128 + 8 * qg);
            float s[8], ss[8];
#pragma unroll
            for (int e = 0; e < 8; ++e) { s[e] = 0.f; ss[e] = 0.f; }
#pragma unroll
            for (int i = 0; i < 4; ++i)
#pragma unroll
                for (int k = 0; k < 4; ++k) { const float a = bf_lo(v[i][k]), b = bf_hi(v[i][k]); s[2 * k] += a; ss[2 * k] += a * a; s[2 * k + 1] += b; ss[2 * k + 1] += b * b; }
#pragma unroll
            for (int e = 0; e < 8; ++e) { s[e] += __shfl_xor(s[e], 16); ss[e] += __shfl_xor(ss[e], 16); s[e] += __shfl_xor(s[e], 32); ss[e] += __shfl_xor(ss[e], 32); }
            if (lane < 16) {
#pragma unroll
                for (int e = 0; e < 8; ++e) red[wave * 128 + 8 * qg + e] = (f32x2){s[e], ss[e]};
            }
            __syncthreads();
            if (tid < 128) { float a = 0.f, b = 0.f;
#pragma unroll
                for (int w = 0; w < 8; ++w) { const f32x2 r = red[w * 128 + tid]; a += r.x; b += r.y; }
                const float mean = a * (1.f / 128.f), var = b * (1.f / 128.f) - mean * mean;
                stat[tid] = (f32x2){mean, 1.0f / sqrtf(fmaxf(var, 0.f) + LN_EPS)}; }
            __syncthreads();
            {
                float mean[8], rstd[8];
#pragma unroll
                for (int e = 0; e < 8; ++e) { const f32x2 st = stat[8 * qg + e]; mean[e] = st.x; rstd[e] = st.y; }
#pragma unroll
                for (int i = 0; i < 4; ++i) { const int d = dsub + 32 * i; const float gam = ng[h * 128 + d], bet = nb[h * 128 + d];
                    v4u o;
#pragma unroll
                    for (int k = 0; k < 4; ++k) o[k] = pg8::cvt_pk_bf16((bf_lo(v[i][k]) - mean[2 * k]) * rstd[2 * k] * gam + bet, (bf_hi(v[i][k]) - mean[2 * k + 1]) * rstd[2 * k + 1] * gam + bet);
                    *(LAS v4u*)(F.lds + d * VT_STRIDE + 16 * qg) = o; }
            }
            __syncthreads();
            bf16x8 wf[4];
#pragma unroll
            for (int kk = 0; kk < 4; ++kk) wf[kk] = *(const bf16x8*)(sgw + ((size_t)(h * 128 + 16 * wave + fr)) * 128 + kk * 32 + 8 * fq);
            f32x4 acc[8];
#pragma unroll
            for (int db = 0; db < 8; ++db) { acc[db] = (f32x4){0.f, 0.f, 0.f, 0.f};
#pragma unroll
                for (int kk = 0; kk < 4; ++kk) { const bf16x8 xf = *(const LAS bf16x8*)(F.lds + (16 * db + fr) * VT_STRIDE + (kk * 32 + 8 * fq) * 2);
                    acc[db] = __builtin_amdgcn_mfma_f32_16x16x32_bf16(xf, wf[kk], acc[db], 0, 0, 0); } }
            {
                const int p = 16 * wave + fr; const float bias = sgb[h * CHUNK + p]; const size_t tok = (size_t)tok0 + p;
#pragma unroll
                for (int db = 0; db < 8; ++db) { const int d = 16 * db + 4 * fq;
                    const v2u gb = *(const v2u*)(F.GB + tok * BW + h * 128 + d);
                    v2u o; o.x = pg8::cvt_pk_bf16(bf_lo(gb.x) * (acc[db][0] + bias), bf_hi(gb.x) * (acc[db][1] + bias));
                    o.y = pg8::cvt_pk_bf16(bf_lo(gb.y) * (acc[db][2] + bias), bf_hi(gb.y) * (acc[db][3] + bias));
                    *(v2u*)(F.MIX + tok * DM + AW + h * 128 + d) = o; }
            }
            __syncthreads();
        }
    }
}

__device__ __forceinline__ float wave_sum(float v) {
#pragma unroll
    for (int o = 1; o < 64; o <<= 1) v += __shfl_xor(v, o);
    return v;
}
__device__ __forceinline__ void ln_phase(Frame& F, int l, bool write_bf) {
    const float* g = F.ln_g + (size_t)l * DM; const float* b = F.ln_b + (size_t)l * DM;
    int tid_ = threadIdx.x; asm volatile("" : "+v"(tid_));
    const int lane_ = tid_ & 63, wave_ = __builtin_amdgcn_readfirstlane(tid_ >> 6);
    const int gw = F.vcu * NWAVES + wave_, NGW = F.G * NWAVES;
    f32x4 gg[4], bb[4];
#pragma unroll
    for (int j = 0; j < 4; ++j) { gg[j] = *((const f32x4*)g + 64 * j + lane_); bb[j] = *((const f32x4*)b + 64 * j + lane_); }
    for (int m = gw; m < NTOK; m += NGW) {
        f32x4* xr = (f32x4*)(F.out + (size_t)m * DM) + lane_;
        f32x4 v[4]; float s = 0.f;
#pragma unroll
        for (int j = 0; j < 4; ++j) { v[j] = xr[64 * j]; s += (v[j].x + v[j].y) + (v[j].z + v[j].w); }
        const float mean = wave_sum(s) * (1.f / DM); float s2 = 0.f;
#pragma unroll
        for (int j = 0; j < 4; ++j) { v[j] = v[j] - mean; s2 += (v[j].x * v[j].x + v[j].y * v[j].y) + (v[j].z * v[j].z + v[j].w * v[j].w); }
        const float rstd = 1.f / sqrtf(wave_sum(s2) * (1.f / DM) + LN_EPS);
#pragma unroll
        for (int j = 0; j < 4; ++j) { v[j] = v[j] * rstd * gg[j] + bb[j]; xr[64 * j] = v[j]; }
        if (write_bf) { v2u* o8 = (v2u*)(F.XB + (size_t)m * DM) + lane_;
#pragma unroll
            for (int j = 0; j < 4; ++j) { v2u o; o.x = pg8::cvt_pk_bf16(v[j].x, v[j].y); o.y = pg8::cvt_pk_bf16(v[j].z, v[j].w); o8[64 * j] = o; } }
    }
}

constexpr int NPHASES = 1 + 4 * DEPTH;
struct Args { const float* in[12]; float* out; unsigned char* ws; int ph_lo, ph_hi; };
__global__ void __launch_bounds__(NWAVES * 64, 2) hybrid_fwd(Args args) {
    extern __shared__ __attribute__((aligned(16))) unsigned char lds[];
    Frame F;
    F.lds = (LAS unsigned char*)lds;
    F.tid = threadIdx.x; F.lane = F.tid & 63; F.wave = __builtin_amdgcn_readfirstlane(F.tid >> 6);
    F.G = gridDim.x; { const int bx = blockIdx.x; F.vcu = (F.G % 8 == 0) ? (bx % 8) * (F.G / 8) + bx / 8 : bx; }
    F.xP = args.in[0]; F.xS = args.in[1]; F.w_in = args.in[2]; F.conv_w = args.in[3]; F.conv_b = args.in[4]; F.sg_w = args.in[5]; F.sg_b = args.in[6];
    F.sg_ng = args.in[7]; F.sg_nb = args.in[8]; F.w_out = args.in[9]; F.ln_g = args.in[10]; F.ln_b = args.in[11]; F.out = args.out;
    unsigned char* ws = args.ws;
    F.WIN = (bf16*)(ws + WS_WIN); F.WOUT = (bf16*)(ws + WS_WOUT); F.SGW = (bf16*)(ws + WS_SGW); F.XB = (bf16*)(ws + WS_XB);
    F.TT = (bf16*)(ws + WS_TT); F.GA = (bf16*)(ws + WS_GA); F.GB = (bf16*)(ws + WS_GB); F.GVT = (bf16*)(ws + WS_GVT); F.MIX = (bf16*)(ws + WS_MIX);
    const int lo = args.ph_lo, hi = args.ph_hi;
#define RUN(k) (lo <= (k) && (k) < hi)
#define SEAM(k) do { if (RUN(k) && RUN((k) + 1)) { cg::this_grid().sync(); } } while (0)
    if (RUN(0)) p0_prologue(F);
    SEAM(0);
    for (int l = 0; l < DEPTH; ++l) {
        const int p = 1 + 4 * l;
        if (RUN(p)) {
            SchedG1 S; S.so.init(NTOK, PROJ, F.G, (int)blockIdx.x); S.X = (const char*)F.XB; S.W = (const char*)(F.WIN + (size_t)l * PROJ * DM);
            EpiG1 E{F.TT, F.GVT};
            pg8::gemm_phase<EpiG1, SchedG1, true, true>(F.lds, DM, S, E);
        }
        SEAM(p);
        if (RUN(p + 1)) mix_phase(F, l);
        SEAM(p + 1);
        if (RUN(p + 2)) {
            SchedG2 S; S.so.init(NTOK, DM, F.G, (int)blockIdx.x); S.A = (const char*)F.MIX; S.B = (const char*)(F.WOUT + (size_t)l * DM * DM);
            EpiG2 E{l == 0 ? F.xP : F.out, l == 0 ? F.xS : F.out + (size_t)NTOK_P * DM, F.out};
            pg8::gemm_phase<EpiG2, SchedG2, true, true>(F.lds, DM, S, E);
        }
        SEAM(p + 2);
        if (RUN(p + 3)) ln_phase(F, l, l + 1 < DEPTH);
        if (l + 1 < DEPTH) SEAM(p + 3);
    }
#undef RUN
#undef SEAM
}

extern "C" void kernel_launch(void* const* d_in, const int* in_sizes, int n_in, void* d_out, int out_size, void* d_ws, size_t ws_size, hipStream_t stream) {
    static int grid = 0;
    if (grid == 0) {
        if (n_in != 12 || in_sizes[0] != NTOK_P * DM || in_sizes[1] != NTOK_S * DM || out_size != NTOK * DM || ws_size < WS_END) {
            fprintf(stderr, "kernel_launch: unexpected shapes (n_in %d, out %d, ws %zu); nothing launched\n", n_in, out_size, ws_size); grid = -1; return; }
        int dev = 0, cus = 0, per_cu = 0;
        if (hipGetDevice(&dev) != hipSuccess || hipDeviceGetAttribute(&cus, hipDeviceAttributeMultiprocessorCount, dev) != hipSuccess) { fprintf(stderr, "kernel_launch: device query failed\n"); grid = -1; return; }
        if (hipFuncSetAttribute((const void*)hybrid_fwd, hipFuncAttributeMaxDynamicSharedMemorySize, LDS_BYTES) != hipSuccess) { fprintf(stderr, "kernel_launch: hipFuncSetAttribute failed\n"); grid = -1; return; }
        if (hipOccupancyMaxActiveBlocksPerMultiprocessor(&per_cu, (const void*)hybrid_fwd, NWAVES * 64, LDS_BYTES) != hipSuccess || per_cu < 1) {
            fprintf(stderr, "kernel_launch: occupancy query reports %d workgroups per CU\n", per_cu); per_cu = 1; }
        (void)hipGetLastError();
        grid = cus;
        if (grid % 8 != 0 || (NTOK / 256 * 14) % grid != 0) fprintf(stderr, "kernel_launch: note: grid %d does not divide the unit counts evenly\n", grid);
    }
    if (grid < 0) return;
    Args a{};
    for (int i = 0; i < 12; ++i) a.in[i] = (const float*)d_in[i];
    a.out = (float*)d_out; a.ws = (unsigned char*)d_ws;
#if MK_N_LAUNCHES == 1
    a.ph_lo = 0; a.ph_hi = NPHASES;
    void* kargs[] = {&a};
    const hipError_t le = hipLaunchCooperativeKernel((const void*)hybrid_fwd, dim3(grid), dim3(NWAVES * 64), kargs, LDS_BYTES, stream);
    if (le != hipSuccess) fprintf(stderr, "kernel_launch: cooperative launch failed: %s (grid %d)\n", hipGetErrorString(le), grid);
#else
    for (int ph = 0; ph < NPHASES; ++ph) {
        a.ph_lo = ph; a.ph_hi = ph + 1;
        hipLaunchKernelGGL(hybrid_fwd, dim3(grid), dim3(NWAVES * 64), LDS_BYTES, stream, a);
        const hipError_t le = hipPeekAtLastError();
        if (le != hipSuccess) { fprintf(stderr, "kernel_launch: launch of phase %d failed: %s\n", ph, hipGetErrorName(le)); break; }
    }
#endif
}
```
